# Optimizing an MI355X kernel written in HIP

```python
import jax, jax.numpy as jnp
from jax import lax
import numpy as np

D_MODEL = 2048
BATCH = 2
SEQ = 4096
DEPTH = 1

D_MIX = D_MODEL
D_POOL = D_MIX // 2
D_LRU = D_MIX - D_POOL
POOL_WINDOWS = (2, 4, 8, 16)
N_POOL_GROUPS = len(POOL_WINDOWS)
POOL_GROUP = D_POOL // N_POOL_GROUPS
N_LRU_HEADS = 8
LRU_HEAD = D_LRU // N_LRU_HEADS
CONV_WIDTH = 4
CONV_PAD = (1, 2)
RG_C = 8.0
D_FF = 4 * D_MODEL
LN_EPS = 1e-5
DEEPNORM_ALPHA = (2 * DEPTH) ** 0.25
DEEPNORM_BETA = (8 * DEPTH) ** -0.25

kernel_name = "hybrid_pool_rglru_deepnorm_encoder"


def layer_norm(x, g, b):
    xf = x.astype(jnp.float32)
    mu = jnp.mean(xf, axis=-1, keepdims=True)
    var = jnp.mean(jnp.square(xf - mu), axis=-1, keepdims=True)
    y = (xf - mu) * lax.rsqrt(var + LN_EPS) * g.astype(jnp.float32) + b.astype(jnp.float32)
    return y.astype(x.dtype)


def window_mean(u, w):
    S = u.shape[1]
    c = jnp.pad(jnp.cumsum(u.astype(jnp.float32), axis=1), ((0, 0), (1, 0), (0, 0)))
    t = jnp.arange(S)
    lo = jnp.clip(t - w // 2, 0, S)
    hi = jnp.clip(t + w // 2, 0, S)
    s = jnp.take(c, hi, axis=1) - jnp.take(c, lo, axis=1)
    cnt = (hi - lo).astype(jnp.float32)
    return s / cnt[None, :, None]


def multiscale_pool(u, w_pool, pool_scale):
    B, S, _ = u.shape
    ug = u.reshape(B, S, N_POOL_GROUPS, POOL_GROUP)
    means = jnp.stack([window_mean(ug[:, :, g], w) for g, w in enumerate(POOL_WINDOWS)], axis=2)
    d = (means - ug.astype(jnp.float32)).astype(u.dtype)
    out = jnp.einsum('bsgi,gio->bsgo', d, w_pool).reshape(B, S, D_POOL)
    return out * pool_scale


def depthwise_conv(u, conv_w, conv_b):
    y = lax.conv_general_dilated(u, conv_w, window_strides=(1,), padding=[CONV_PAD],
                                 dimension_numbers=('NWC', 'WIO', 'NWC'),
                                 feature_group_count=u.shape[-1])
    return y + conv_b


def _combine(c1, c2):
    a1, b1 = c1
    a2, b2 = c2
    return a1 * a2, a2 * b1 + b2


def linear_scan(a, b, reverse):
    return lax.associative_scan(_combine, (a, b), reverse=reverse, axis=1)[1]


def rg_lru_bidirectional(xc, w_a, b_a, w_i, b_i, lam):
    B, S, C = xc.shape
    xh = xc.reshape(B, S, N_LRU_HEADS, LRU_HEAD)
    pre_r = jnp.einsum('bshi,nhio->nbsho', xh, w_a).reshape(2, B, S, C)
    pre_i = jnp.einsum('bshi,nhio->nbsho', xh, w_i).reshape(2, B, S, C)
    r = jax.nn.sigmoid(pre_r.astype(jnp.float32) + b_a.astype(jnp.float32)[:, None, None, :])
    i = jax.nn.sigmoid(pre_i.astype(jnp.float32) + b_i.astype(jnp.float32)[:, None, None, :])
    log_a = -RG_C * r * jax.nn.softplus(-lam.astype(jnp.float32))[:, None, None, :]
    a = jnp.exp(log_a)
    mult = jnp.sqrt(-jnp.expm1(2.0 * log_a))
    b = mult * i * xc.astype(jnp.float32)[None]
    h_fwd = linear_scan(a[0], b[0], False)
    h_bwd = linear_scan(a[1], b[1], True)
    return (h_fwd + h_bwd).astype(xc.dtype)


def hybrid_mixer(x, w_in, w_pool, pool_scale, conv_w, conv_b,
                 w_rg_a, b_rg_a, w_rg_i, b_rg_i, rg_lambda, w_out):
    proj = jnp.einsum('bsd,de->bse', x, w_in)
    u_pool = proj[..., :D_POOL]
    u_rec = proj[..., D_POOL:D_POOL + D_LRU]
    u_gate = proj[..., D_POOL + D_LRU:]
    y_pool = multiscale_pool(u_pool, w_pool, pool_scale)
    xc = depthwise_conv(u_rec, conv_w, conv_b)
    h = rg_lru_bidirectional(xc, w_rg_a, b_rg_a, w_rg_i, b_rg_i, rg_lambda)
    y_rec = h * jax.nn.gelu(u_gate)
    y = jnp.concatenate([y_pool, y_rec], axis=-1)
    return jnp.einsum('bse,ed->bsd', y, w_out)


def squared_relu_mlp(x, w1, w2):
    h = jnp.square(jax.nn.relu(jnp.einsum('bsd,df->bsf', x, w1)))
    return jnp.einsum('bsf,fd->bsd', h, w2)


def setup_inputs(seed: int = 0) -> dict:
    key = jax.random.key(seed)
    ks = jax.random.split(key, 20)
    f32 = jnp.float32

    def nrm(k, shape, scale):
        return jax.random.normal(k, shape, f32) * scale

    x = jax.random.normal(ks[0], (BATCH, SEQ, D_MODEL), f32)
    ln_mix_g = 1.0 + nrm(ks[1], (DEPTH, D_MODEL), 0.02)
    ln_mix_b = nrm(ks[2], (DEPTH, D_MODEL), 0.02)
    w_in = nrm(ks[3], (DEPTH, D_MODEL, D_POOL + 2 * D_LRU), D_MODEL ** -0.5)
    w_pool = nrm(ks[4], (DEPTH, N_POOL_GROUPS, POOL_GROUP, POOL_GROUP), POOL_GROUP ** -0.5)
    pool_scale = 1.0 + nrm(ks[5], (DEPTH, D_POOL), 0.1)
    conv_w = nrm(ks[6], (DEPTH, CONV_WIDTH, 1, D_LRU), CONV_WIDTH ** -0.5)
    conv_b = nrm(ks[7], (DEPTH, D_LRU), 0.02)
    w_rg_a = nrm(ks[8], (DEPTH, 2, N_LRU_HEADS, LRU_HEAD, LRU_HEAD), LRU_HEAD ** -0.5)
    b_rg_a = nrm(ks[9], (DEPTH, 2, D_LRU), 0.02)
    w_rg_i = nrm(ks[10], (DEPTH, 2, N_LRU_HEADS, LRU_HEAD, LRU_HEAD), LRU_HEAD ** -0.5)
    b_rg_i = nrm(ks[11], (DEPTH, 2, D_LRU), 0.02)
    u = jax.random.uniform(ks[12], (DEPTH, 2, D_LRU), f32, minval=0.9, maxval=0.999)
    s = u ** (1.0 / RG_C)
    rg_lambda = jnp.log(s) - jnp.log1p(-s)
    w_out = nrm(ks[13], (DEPTH, D_MIX, D_MODEL), D_MIX ** -0.5 * DEEPNORM_BETA)
    ln_ffn_g = 1.0 + nrm(ks[14], (DEPTH, D_MODEL), 0.02)
    ln_ffn_b = nrm(ks[15], (DEPTH, D_MODEL), 0.02)
    w_mlp_in = nrm(ks[16], (DEPTH, D_MODEL, D_FF), D_MODEL ** -0.5 * DEEPNORM_BETA)
    w_mlp_out = nrm(ks[17], (DEPTH, D_FF, D_MODEL), D_FF ** -0.5 * DEEPNORM_BETA)
    return {"x": x, "ln_mix_g": ln_mix_g, "ln_mix_b": ln_mix_b, "w_in": w_in,
            "w_pool": w_pool, "pool_scale": pool_scale, "conv_w": conv_w, "conv_b": conv_b,
            "w_rg_a": w_rg_a, "b_rg_a": b_rg_a, "w_rg_i": w_rg_i, "b_rg_i": b_rg_i,
            "rg_lambda": rg_lambda, "w_out": w_out, "ln_ffn_g": ln_ffn_g, "ln_ffn_b": ln_ffn_b,
            "w_mlp_in": w_mlp_in, "w_mlp_out": w_mlp_out}


def reference(x, ln_mix_g, ln_mix_b, w_in, w_pool, pool_scale, conv_w, conv_b,
              w_rg_a, b_rg_a, w_rg_i, b_rg_i, rg_lambda, w_out, ln_ffn_g, ln_ffn_b,
              w_mlp_in, w_mlp_out):
    for l in range(DEPTH):
        mix = hybrid_mixer(x, w_in[l], w_pool[l], pool_scale[l], conv_w[l], conv_b[l],
                           w_rg_a[l], b_rg_a[l], w_rg_i[l], b_rg_i[l], rg_lambda[l], w_out[l])
        x = layer_norm(DEEPNORM_ALPHA * x + mix, ln_mix_g[l], ln_mix_b[l])
        ffn = squared_relu_mlp(x, w_mlp_in[l], w_mlp_out[l])
        x = layer_norm(DEEPNORM_ALPHA * x + ffn, ln_ffn_g[l], ln_ffn_b[l])
    return x
```

```cpp
#include <hip/hip_runtime.h>
#include <cstdio>
#include <cstdint>

constexpr int BATCH = 2, SEQ = 4096, D = 2048, M = BATCH * SEQ, DPOOL = 1024, DLRU = 1024, NPROJ = 3072, FF = 8192;
constexpr int NGRP = 4, PGW = 256, NH = 8, HD = 128;
constexpr float LN_EPS = 1e-5f;
constexpr float ALPHA = 1.189207115002721f;

typedef unsigned short bf16;
typedef short bf16x8 __attribute__((ext_vector_type(8)));
typedef float f32x4 __attribute__((ext_vector_type(4)));

__device__ __forceinline__ unsigned f2bf(float f) { unsigned u = __builtin_bit_cast(unsigned, f); return (u + 0x7fffu + ((u >> 16) & 1u)) >> 16; }
__device__ __forceinline__ float bf2f(bf16 h) { return __builtin_bit_cast(float, (unsigned)h << 16); }

constexpr size_t MiB = 1u << 20;
constexpr size_t WS_CTL = 0;
constexpr size_t WS_WPOOL_T = 1 * MiB;
constexpr size_t WS_WG_T = 1 * MiB + 512 * 1024;
constexpr size_t WS_XBUF1 = 2 * MiB + 512 * 1024, WS_XBUF2 = 3 * MiB;
constexpr size_t WS_WIN_T = 4 * MiB, WS_WOUT_T = 16 * MiB, WS_W1_T = 24 * MiB, WS_W2_T = 56 * MiB;
constexpr size_t WS_XN = 88 * MiB;
constexpr size_t WS_H = 120 * MiB;
constexpr size_t WS_PROJ = 120 * MiB;
constexpr size_t WS_XB = 168 * MiB;
constexpr size_t WS_Y = 168 * MiB;
constexpr size_t WS_DBUF = 200 * MiB;
constexpr size_t WS_SUM = 216 * MiB, WS_CIN = 218 * MiB;
constexpr size_t WS_HS = 219 * MiB;

namespace nv {
__global__ void k_cvt(const float* __restrict__ x, bf16* __restrict__ o, size_t n) {
    for (size_t i = (size_t)blockIdx.x * blockDim.x + threadIdx.x; i < n; i += (size_t)gridDim.x * blockDim.x) o[i] = (bf16)f2bf(x[i]);
}
__global__ void k_transpose(const float* __restrict__ W, bf16* __restrict__ Wt, int K, int N) {
    const size_t tot = (size_t)K * N;
    for (size_t i = (size_t)blockIdx.x * blockDim.x + threadIdx.x; i < tot; i += (size_t)gridDim.x * blockDim.x) {
        const int n = (int)(i / K), k = (int)(i % K);
        Wt[i] = (bf16)f2bf(W[(size_t)k * N + n]);
    }
}
struct GemmArgs {
    const bf16* A; const bf16* Bt; int lda, ldb, K, ngroup;
    bf16* Ob; float* Of; int ldc; int pad; const float* aux; const float* res;
};
template <int MODE> __global__ __launch_bounds__(256) void k_gemm(GemmArgs g) {
    const int wave = threadIdx.x >> 6, lane = threadIdx.x & 63, fr = lane & 15, fq = lane >> 4;
    const int m0 = blockIdx.y * 64 + (wave >> 1) * 32, n0 = blockIdx.x * 64 + (wave & 1) * 32;
    const bf16* A = g.A + (size_t)((blockIdx.x * 64) / g.ngroup) * g.K;
    f32x4 acc[2][2];
    for (int i = 0; i < 2; ++i) for (int j = 0; j < 2; ++j) acc[i][j] = (f32x4){0.f, 0.f, 0.f, 0.f};
    for (int k0 = 0; k0 < g.K; k0 += 32) {
        bf16x8 a[2], b[2];
        for (int i = 0; i < 2; ++i) a[i] = *(const bf16x8*)(A + (size_t)(m0 + 16 * i + fr) * g.lda + k0 + 8 * fq);
        for (int j = 0; j < 2; ++j) b[j] = *(const bf16x8*)(g.Bt + (size_t)(n0 + 16 * j + fr) * g.ldb + k0 + 8 * fq);
        for (int i = 0; i < 2; ++i) for (int j = 0; j < 2; ++j) acc[i][j] = __builtin_amdgcn_mfma_f32_16x16x32_bf16(a[i], b[j], acc[i][j], 0, 0, 0);
    }
    for (int i = 0; i < 2; ++i) for (int j = 0; j < 2; ++j) for (int r = 0; r < 4; ++r) {
        const int m = m0 + 16 * i + 4 * fq + r, n = n0 + 16 * j + fr; const float v = acc[i][j][r];
        const size_t o = (size_t)m * g.ldc + n;
        if (MODE == 0) g.Ob[o] = (bf16)f2bf(v);
        else if (MODE == 1) g.Ob[o] = (bf16)f2bf(v * g.aux[n]);
        else if (MODE == 2) g.Of[o] = ALPHA * g.res[o] + v;
        else { const float t = v > 0.f ? v : 0.f; g.Ob[o] = (bf16)f2bf(t * t); }
    }
}
__global__ void k_pool_d(const bf16* __restrict__ proj, bf16* __restrict__ dbuf) {
    const size_t i = (size_t)blockIdx.x * blockDim.x + threadIdx.x; if (i >= (size_t)M * DPOOL) return;
    const int m = (int)(i / DPOOL), c = (int)(i % DPOOL), g = c / PGW, w = 2 << g, b = m / SEQ, t = m % SEQ;
    const int lo = max(t - w / 2, 0), hi = min(t + w / 2, SEQ);
    float s = 0.f; for (int q = lo; q < hi; ++q) s += bf2f(proj[(size_t)(b * SEQ + q) * NPROJ + c]);
    const float d = s / (float)(hi - lo) - bf2f(proj[(size_t)m * NPROJ + c]);
    dbuf[i] = (bf16)f2bf(d);
}
__global__ __launch_bounds__(128) void k_lru(const bf16* __restrict__ proj, const float* __restrict__ conv_w, const float* __restrict__ conv_b,
                                             const float* __restrict__ w_a, const float* __restrict__ b_a, const float* __restrict__ w_i, const float* __restrict__ b_i,
                                             const float* __restrict__ lam, float* __restrict__ HS, int dir) {
    __shared__ float xs[HD];
    const int b = blockIdx.x / NH, h = blockIdx.x % NH, c = threadIdx.x, hc = h * HD + c;
    const float cw0 = conv_w[0 * DLRU + hc], cw1 = conv_w[1 * DLRU + hc], cw2 = conv_w[2 * DLRU + hc], cw3 = conv_w[3 * DLRU + hc], cb = conv_b[hc];
    const float ba = b_a[dir * DLRU + hc], bi = b_i[dir * DLRU + hc];
    const float sp = log1pf(expf(-lam[dir * DLRU + hc]));
    const float* wa = w_a + ((size_t)(dir * NH + h) * HD) * HD + c;
    const float* wi = w_i + ((size_t)(dir * NH + h) * HD) * HD + c;
    float hst = 0.f;
    for (int s = 0; s < SEQ; ++s) {
        const int t = dir ? (SEQ - 1 - s) : s;
        float xc = cb;
        { const size_t base = (size_t)(b * SEQ) * NPROJ + DPOOL + hc;
          if (t - 1 >= 0) xc += bf2f(proj[base + (size_t)(t - 1) * NPROJ]) * cw0;
          xc += bf2f(proj[base + (size_t)t * NPROJ]) * cw1;
          if (t + 1 < SEQ) xc += bf2f(proj[base + (size_t)(t + 1) * NPROJ]) * cw2;
          if (t + 2 < SEQ) xc += bf2f(proj[base + (size_t)(t + 2) * NPROJ]) * cw3; }
        xs[c] = xc; __syncthreads();
        float pr = 0.f, pi = 0.f;
        for (int i = 0; i < HD; ++i) { const float xv = xs[i]; pr += xv * wa[(size_t)i * HD]; pi += xv * wi[(size_t)i * HD]; }
        const float r = 1.f / (1.f + expf(-(pr + ba))), ig = 1.f / (1.f + expf(-(pi + bi)));
        const float la = -8.f * r * sp, a = expf(la), mult = sqrtf(-expm1f(2.f * la));
        hst = a * hst + mult * ig * xc;
        const size_t o = (size_t)(b * SEQ + t) * DLRU + hc;
        if (dir == 0) HS[o] = hst; else HS[o] += hst;
        __syncthreads();
    }
}
__global__ void k_yrec(const bf16* __restrict__ proj, const float* __restrict__ HS, bf16* __restrict__ y) {
    const size_t i = (size_t)blockIdx.x * blockDim.x + threadIdx.x; if (i >= (size_t)M * DLRU) return;
    const int m = (int)(i / DLRU), c = (int)(i % DLRU);
    const float x = bf2f(proj[(size_t)m * NPROJ + DPOOL + DLRU + c]);
    const float gl = 0.5f * x * (1.f + tanhf(0.7978845608028654f * (x + 0.044715f * x * x * x)));
    y[(size_t)m * D + DPOOL + c] = (bf16)f2bf(HS[i] * gl);
}
__global__ __launch_bounds__(256) void k_ln(float* __restrict__ v, const float* __restrict__ g, const float* __restrict__ bta, bf16* __restrict__ xn) {
    const int row = blockIdx.x * 4 + (threadIdx.x >> 6), lane = threadIdx.x & 63; if (row >= M) return;
    float* p = v + (size_t)row * D; f32x4 x[8]; float s = 0.f;
    for (int j = 0; j < 8; ++j) { x[j] = *(const f32x4*)(p + 256 * j + 4 * lane); s += (x[j][0] + x[j][1]) + (x[j][2] + x[j][3]); }
    for (int o = 1; o < 64; o <<= 1) s += __shfl_xor(s, o);
    const float mean = s * (1.f / D); float q = 0.f;
    for (int j = 0; j < 8; ++j) { x[j] = x[j] - mean; q += (x[j][0] * x[j][0] + x[j][1] * x[j][1]) + (x[j][2] * x[j][2] + x[j][3] * x[j][3]); }
    for (int o = 1; o < 64; o <<= 1) q += __shfl_xor(q, o);
    const float rstd = 1.f / sqrtf(q * (1.f / D) + LN_EPS);
    for (int j = 0; j < 8; ++j) { const int c0 = 256 * j + 4 * lane; const f32x4 gg = *(const f32x4*)(g + c0), bb = *(const f32x4*)(bta + c0);
        const f32x4 o = x[j] * rstd * gg + bb; *(f32x4*)(p + c0) = o;
        if (xn) { bf16* q2 = xn + (size_t)row * D + c0; q2[0] = (bf16)f2bf(o[0]); q2[1] = (bf16)f2bf(o[1]); q2[2] = (bf16)f2bf(o[2]); q2[3] = (bf16)f2bf(o[3]); } }
}
}

extern "C" void kernel_launch(void* const* d_in, const int* in_sizes, int n_in, void* d_out, int out_size, void* d_ws, size_t ws_size, hipStream_t stream) {
    if (n_in != 18 || out_size != M * D || ws_size < 256 * MiB) { fprintf(stderr, "kernel_launch: unexpected shapes (n_in %d out %d ws %zu)\n", n_in, out_size, ws_size); return; }
    const float* x = (const float*)d_in[0]; const float* ln1g = (const float*)d_in[1]; const float* ln1b = (const float*)d_in[2];
    const float* w_in = (const float*)d_in[3]; const float* w_pool = (const float*)d_in[4]; const float* pool_scale = (const float*)d_in[5];
    const float* conv_w = (const float*)d_in[6]; const float* conv_b = (const float*)d_in[7];
    const float* w_rg_a = (const float*)d_in[8]; const float* b_rg_a = (const float*)d_in[9]; const float* w_rg_i = (const float*)d_in[10]; const float* b_rg_i = (const float*)d_in[11];
    const float* lam = (const float*)d_in[12]; const float* w_out = (const float*)d_in[13]; const float* ln2g = (const float*)d_in[14]; const float* ln2b = (const float*)d_in[15];
    const float* w1 = (const float*)d_in[16]; const float* w2 = (const float*)d_in[17];
    unsigned char* ws = (unsigned char*)d_ws; float* out = (float*)d_out;
    bf16* xb = (bf16*)(ws + WS_XB); bf16* win_t = (bf16*)(ws + WS_WIN_T); bf16* wout_t = (bf16*)(ws + WS_WOUT_T); bf16* w1_t = (bf16*)(ws + WS_W1_T); bf16* w2_t = (bf16*)(ws + WS_W2_T);
    bf16* wpool_t = (bf16*)(ws + WS_WPOOL_T); bf16* proj = (bf16*)(ws + WS_PROJ); bf16* dbuf = (bf16*)(ws + WS_DBUF); bf16* y = (bf16*)(ws + WS_Y); bf16* xn = (bf16*)(ws + WS_XN);
    bf16* hb = (bf16*)(ws + WS_H); float* HS = (float*)(ws + WS_HS);
    nv::k_cvt<<<2048, 256, 0, stream>>>(x, xb, (size_t)M * D);
    nv::k_transpose<<<2048, 256, 0, stream>>>(w_in, win_t, D, NPROJ);
    nv::k_transpose<<<2048, 256, 0, stream>>>(w_out, wout_t, D, D);
    nv::k_transpose<<<2048, 256, 0, stream>>>(w1, w1_t, D, FF);
    nv::k_transpose<<<2048, 256, 0, stream>>>(w2, w2_t, FF, D);
    for (int g = 0; g < NGRP; ++g) nv::k_transpose<<<64, 256, 0, stream>>>(w_pool + (size_t)g * PGW * PGW, wpool_t + (size_t)g * PGW * PGW, PGW, PGW);
    { nv::GemmArgs a{xb, win_t, D, D, D, 1 << 30, proj, nullptr, NPROJ, 0, nullptr, nullptr}; nv::k_gemm<0><<<dim3(NPROJ / 64, M / 64), 256, 0, stream>>>(a); }
    nv::k_pool_d<<<(M * DPOOL) / 256, 256, 0, stream>>>(proj, dbuf);
    nv::k_lru<<<BATCH * NH, HD, 0, stream>>>(proj, conv_w, conv_b, w_rg_a, b_rg_a, w_rg_i, b_rg_i, lam, HS, 0);
    nv::k_lru<<<BATCH * NH, HD, 0, stream>>>(proj, conv_w, conv_b, w_rg_a, b_rg_a, w_rg_i, b_rg_i, lam, HS, 1);
    { nv::GemmArgs a{dbuf, wpool_t, DPOOL, PGW, PGW, PGW, y, nullptr, D, 0, pool_scale, nullptr}; nv::k_gemm<1><<<dim3(DPOOL / 64, M / 64), 256, 0, stream>>>(a); }
    nv::k_yrec<<<(M * DLRU) / 256, 256, 0, stream>>>(proj, HS, y);
    { nv::GemmArgs a{y, wout_t, D, D, D, 1 << 30, nullptr, out, D, 0, nullptr, x}; nv::k_gemm<2><<<dim3(D / 64, M / 64), 256, 0, stream>>>(a); }
    nv::k_ln<<<M / 4, 256, 0, stream>>>(out, ln1g, ln1b, xn);
    { nv::GemmArgs a{xn, w1_t, D, D, D, 1 << 30, hb, nullptr, FF, 0, nullptr, nullptr}; nv::k_gemm<3><<<dim3(FF / 64, M / 64), 256, 0, stream>>>(a); }
    { nv::GemmArgs a{hb, w2_t, FF, FF, FF, 1 << 30, nullptr, out, D, 0, nullptr, out}; nv::k_gemm<2><<<dim3(D / 64, M / 64), 256, 0, stream>>>(a); }
    nv::k_ln<<<M / 4, 256, 0, stream>>>(out, ln2g, ln2b, nullptr);
}
```
